# Optimizing an MI355X kernel written in HIP

```python
import math
import jax, jax.numpy as jnp
from jax import lax
import numpy as np

D_MODEL = 1024
BATCH = 8
SEQ = 2048
DEPTH = 2

N_A_LAYERS = DEPTH // 2
N_B_LAYERS = DEPTH - N_A_LAYERS
S5_GROUP = 16
S5_GROUPS = D_MODEL // S5_GROUP
S5_STATE = 64
DT_MIN = 1e-3
DT_MAX = 1e-1
LAMBDA_RE_MAX = -1e-4
HEAD_DIM = 64
N_Q_HEADS = D_MODEL // HEAD_DIM
N_KV_HEADS = 4
Q_PER_KV = N_Q_HEADS // N_KV_HEADS
WINDOW = 128
BLOCK = 128
D_FF = 4 * D_MODEL
NORM_EPS = 1e-5

kernel_name = "yoco_s5_swa_sink_hybrid"


def rmsnorm(x, g):
    x32 = x.astype(jnp.float32)
    y = x32 * lax.rsqrt(jnp.mean(x32 * x32, axis=-1, keepdims=True) + NORM_EPS)
    return (y * g.astype(jnp.float32)).astype(x.dtype)


def s5_mixer(u, a_re, a_im, log_dt, b_re, b_im, c_re, c_im, d_skip, w_glu, b_glu):
    bsz, seq, _ = u.shape
    f32 = jnp.float32
    u32 = u.astype(f32)
    ug = u32.reshape(bsz, seq, S5_GROUPS, S5_GROUP)
    lam = lax.complex(jnp.minimum(a_re.astype(f32), LAMBDA_RE_MAX), a_im.astype(f32))
    dt = jnp.exp(log_dt.astype(f32))[:, None]
    lam_bar = jnp.exp(lam * dt)
    b_c = lax.complex(b_re.astype(f32), b_im.astype(f32))
    b_bar = ((lam_bar - 1.0) / lam)[:, :, None] * b_c
    bu = lax.complex(jnp.einsum('blgc,gpc->blgp', ug, jnp.real(b_bar)),
                     jnp.einsum('blgc,gpc->blgp', ug, jnp.imag(b_bar)))
    a = jnp.broadcast_to(lam_bar[None, None], (1, seq, S5_GROUPS, S5_STATE))

    def combine(left, right):
        a_l, b_l = left
        a_r, b_r = right
        return a_r * a_l, a_r * b_l + b_r

    _, states = lax.associative_scan(combine, (a, bu), axis=1)
    y = (jnp.einsum('blgp,gcp->blgc', jnp.real(states), c_re.astype(f32))
         - jnp.einsum('blgp,gcp->blgc', jnp.imag(states), c_im.astype(f32)))
    y = y.reshape(bsz, seq, D_MODEL) + d_skip.astype(f32) * u32
    y = jax.nn.gelu(y).astype(u.dtype)
    z = y @ w_glu + b_glu
    val, gate = jnp.split(z, 2, axis=-1)
    return val * jax.nn.sigmoid(gate)


def shared_kv(h, g_kv, w_kv, b_kv):
    bsz, seq, _ = h.shape
    kv = rmsnorm(h, g_kv) @ w_kv + b_kv
    k, v = jnp.split(kv, 2, axis=-1)
    return (k.reshape(bsz, seq, N_KV_HEADS, HEAD_DIM),
            v.reshape(bsz, seq, N_KV_HEADS, HEAD_DIM))


def window_blocks(t, nb):
    bsz = t.shape[0]
    tb = t.reshape(bsz, nb, BLOCK, N_KV_HEADS, HEAD_DIM)
    prev = jnp.concatenate([jnp.zeros_like(tb[:, :1]), tb[:, :-1]], axis=1)
    return jnp.moveaxis(jnp.concatenate([prev, tb], axis=2), 1, 0)


def swa_sink_attention(hn, k, v, w_q, b_q, sinks, w_o, b_o):
    bsz, seq, _ = hn.shape
    nb = seq // BLOCK
    f32 = jnp.float32
    scale = 1.0 / math.sqrt(HEAD_DIM)
    q = (hn @ w_q + b_q).reshape(bsz, nb, BLOCK, N_KV_HEADS, Q_PER_KV, HEAD_DIM)
    q = jnp.moveaxis(q, 1, 0)
    kw = window_blocks(k, nb)
    vw = window_blocks(v, nb)
    qi = jnp.arange(BLOCK)[:, None]
    kj = jnp.arange(2 * BLOCK)[None, :]
    diff = qi + BLOCK - kj
    band = (diff >= 0) & (diff < WINDOW)
    sink = sinks.astype(f32).reshape(N_KV_HEADS, Q_PER_KV)[None, :, :, None]

    def block_fn(args):
        n, qb, kb, vb = args
        s = jnp.einsum('bqkgd,bskd->bkgqs', qb.astype(f32), kb.astype(f32)) * scale
        valid = band & ((n - 1) * BLOCK + kj >= 0)
        s = jnp.where(valid, s, -jnp.inf)
        m = jnp.maximum(jnp.max(s, axis=-1), sink)
        p = jnp.exp(s - m[..., None])
        denom = jnp.sum(p, axis=-1) + jnp.exp(sink - m)
        o = jnp.einsum('bkgqs,bskd->bqkgd', p / denom[..., None], vb.astype(f32))
        return o.astype(hn.dtype)

    o = lax.map(block_fn, (jnp.arange(nb), q, kw, vw))
    o = jnp.moveaxis(o, 0, 1).reshape(bsz, seq, N_Q_HEADS * HEAD_DIM)
    return o @ w_o + b_o


def sq_relu_mlp(h, w_in, w_out):
    return jnp.square(jax.nn.relu(h @ w_in)) @ w_out


def setup_inputs(seed: int = 0) -> dict:
    key = jax.random.key(seed)
    ks = jax.random.split(key, 26)
    f32 = jnp.float32
    nrm = lambda k, shape, s: jax.random.normal(k, shape, f32) * s
    G, P, GC, D = S5_GROUPS, S5_STATE, S5_GROUP, D_MODEL
    HQ = N_Q_HEADS * HEAD_DIM
    HKV = N_KV_HEADS * HEAD_DIM
    x = jax.random.normal(ks[0], (BATCH, SEQ, D), f32)
    norm_mix = 1.0 + nrm(ks[1], (DEPTH, D), 0.02)
    norm_mlp = 1.0 + nrm(ks[2], (DEPTH, D), 0.02)
    norm_kv = 1.0 + nrm(ks[3], (D,), 0.02)
    norm_final = 1.0 + nrm(ks[4], (D,), 0.02)
    s5_a_re = -0.5 + nrm(ks[5], (N_A_LAYERS, G, P), 0.01)
    s5_a_im = (jnp.pi * jnp.arange(P, dtype=f32))[None, None, :] + nrm(ks[6], (N_A_LAYERS, G, P), 0.01)
    s5_log_dt = jax.random.uniform(ks[7], (N_A_LAYERS, G), f32, math.log(DT_MIN), math.log(DT_MAX))
    s5_b_re = nrm(ks[8], (N_A_LAYERS, G, P, GC), (2.0 * GC) ** -0.5)
    s5_b_im = nrm(ks[9], (N_A_LAYERS, G, P, GC), (2.0 * GC) ** -0.5)
    s5_c_re = nrm(ks[10], (N_A_LAYERS, G, GC, P), P ** -0.5)
    s5_c_im = nrm(ks[11], (N_A_LAYERS, G, GC, P), P ** -0.5)
    s5_d = nrm(ks[12], (N_A_LAYERS, D), 1.0)
    s5_w_glu = nrm(ks[13], (N_A_LAYERS, D, 2 * D), D ** -0.5)
    s5_b_glu = nrm(ks[14], (N_A_LAYERS, 2 * D), 0.01)
    w_kv = nrm(ks[15], (D, 2 * HKV), D ** -0.5)
    b_kv = nrm(ks[16], (2 * HKV,), 0.01)
    w_q = nrm(ks[17], (N_B_LAYERS, D, HQ), D ** -0.5)
    b_q = nrm(ks[18], (N_B_LAYERS, HQ), 0.01)
    sinks = nrm(ks[19], (N_B_LAYERS, N_Q_HEADS), 0.5)
    w_o = nrm(ks[20], (N_B_LAYERS, HQ, D), HQ ** -0.5)
    b_o = nrm(ks[21], (N_B_LAYERS, D), 0.01)
    w_mlp_in = nrm(ks[22], (DEPTH, D, D_FF), D ** -0.5)
    w_mlp_out = nrm(ks[23], (DEPTH, D_FF, D), D_FF ** -0.5)
    return {"x": x, "norm_mix": norm_mix, "norm_mlp": norm_mlp, "norm_kv": norm_kv,
            "norm_final": norm_final, "s5_a_re": s5_a_re, "s5_a_im": s5_a_im,
            "s5_log_dt": s5_log_dt, "s5_b_re": s5_b_re, "s5_b_im": s5_b_im,
            "s5_c_re": s5_c_re, "s5_c_im": s5_c_im, "s5_d": s5_d, "s5_w_glu": s5_w_glu,
            "s5_b_glu": s5_b_glu, "w_kv": w_kv, "b_kv": b_kv, "w_q": w_q, "b_q": b_q,
            "sinks": sinks, "w_o": w_o, "b_o": b_o, "w_mlp_in": w_mlp_in,
            "w_mlp_out": w_mlp_out}


def reference(x, norm_mix, norm_mlp, norm_kv, norm_final, s5_a_re, s5_a_im, s5_log_dt,
              s5_b_re, s5_b_im, s5_c_re, s5_c_im, s5_d, s5_w_glu, s5_b_glu, w_kv, b_kv,
              w_q, b_q, sinks, w_o, b_o, w_mlp_in, w_mlp_out):
    h = x
    k = v = None
    for layer in range(DEPTH):
        if layer < N_A_LAYERS:
            hn = rmsnorm(h, norm_mix[layer])
            h = h + s5_mixer(hn, s5_a_re[layer], s5_a_im[layer], s5_log_dt[layer],
                             s5_b_re[layer], s5_b_im[layer], s5_c_re[layer], s5_c_im[layer],
                             s5_d[layer], s5_w_glu[layer], s5_b_glu[layer])
        else:
            if layer == N_A_LAYERS:
                k, v = shared_kv(h, norm_kv, w_kv, b_kv)
            bi = layer - N_A_LAYERS
            hn = rmsnorm(h, norm_mix[layer])
            h = h + swa_sink_attention(hn, k, v, w_q[bi], b_q[bi], sinks[bi], w_o[bi], b_o[bi])
        h = h + sq_relu_mlp(rmsnorm(h, norm_mlp[layer]), w_mlp_in[layer], w_mlp_out[layer])
    return rmsnorm(h, norm_final)
```

```cpp
#include <hip/hip_runtime.h>
#include <cstdio>
#include <cstdint>
namespace pg8 {
#define PG8_LAS __attribute__((address_space(3)))
typedef unsigned short bf16_t;
typedef short bf16x8 __attribute__((ext_vector_type(8)));
typedef float f32x4 __attribute__((ext_vector_type(4)));
typedef unsigned u32x4 __attribute__((ext_vector_type(4)));
constexpr int BM = 256, BK = 64, HALF = 128, HTB = HALF * BK * 2  , STAGE_BYTES = 8 * HTB, NXCD = 8, WGM = 8;

__host__ __device__ __forceinline__ int lds_byte(int r, int c) { const int st = (r >> 4) * 2 + (c >> 5), rr = r & 15, cc = c & 31, ob = rr * 64 + cc * 2; return st * 1024 + (ob ^ (((ob >> 9) & 1) << 5)); }
__host__ __device__ __forceinline__ void stage_rc(int b, int& R, int& C) { const int st = b / 1024, sb = b % 1024, swz = sb ^ (((sb >> 9) & 1) << 5); R = (st >> 1) * 16 + swz / 64; C = (st & 1) * 32 + (swz % 64) / 2; }
__host__ __device__ __forceinline__ int perm32(int rho) { const int n = rho >> 4, i = rho & 15; return 8 * (i >> 2) + 4 * n + (i & 3); }

struct Unit { int pm, pn; };
struct Gemm { const bf16_t* A; const bf16_t* Bt; int M, N, K, lda, ldb; };

struct StaticOrder {
    int nM, nN, nwg, G, c;
    __host__ __device__ void init(int M, int N, int G_, int c_) { nM = M / BM; nN = N / BM; nwg = nM * nN; G = G_; c = c_; }
    __host__ __device__ bool next(int i, Unit& u) const {
        const long L = (long)i * G + c; if (L >= nwg) return false;
        int wgid = (int)L; { const int q = nwg / NXCD, r = nwg % NXCD, xcd = wgid % NXCD, off = wgid / NXCD; wgid = (xcd < r ? xcd * (q + 1) : r * (q + 1) + (xcd - r) * q) + off; }
        const int nig = WGM * nN, gid = wgid / nig, fm = gid * WGM, gsz = (nM - fm) < WGM ? (nM - fm) : WGM;
        u.pm = fm + ((wgid % nig) % gsz); u.pn = (wgid % nig) / gsz; return true;
    }
    __device__ __forceinline__ void a_ready(const Unit&) const {}
    __device__ __forceinline__ void done(const Unit&) const {}
};

__device__ __forceinline__ unsigned cvt_pk_bf16(float lo, float hi) { unsigned r; asm volatile("v_cvt_pk_bf16_f32 %0, %1, %2" : "=v"(r) : "v"(lo), "v"(hi)); return r; }
__device__ __forceinline__ float bf_lo(unsigned w) { return __uint_as_float(w << 16); }
__device__ __forceinline__ float bf_hi(unsigned w) { return __uint_as_float(w & 0xffff0000u); }
constexpr float RMS_EPS = 1e-5f;
constexpr float LOG2E = 1.4426950408889634f;
__device__ __forceinline__ float fast_sigmoid(float x) { return __builtin_amdgcn_rcpf(1.0f + __builtin_amdgcn_exp2f(-LOG2E * x)); }
__device__ __forceinline__ float gelu_tanh_f(float x) { const float z2 = 1.5957691216057308f * (x + 0.044715f * x * x * x); return x * fast_sigmoid(z2); }

struct EpiCarryOut {
    static constexpr bool PERM = false, AFTER_DRAIN = false;
    float* Eloc;
    __device__ __forceinline__ void operator()(const f32x4 (&acc)[2][2][4][2], const Unit& u, int wr, int wc, int fr, int fq) const {
        const int row0 = u.pm * BM + wr * 64 + fr, col0 = wc * 32 + 4 * fq;
#pragma unroll
        for (int ai = 0; ai < 2; ++ai)
#pragma unroll
            for (int m = 0; m < 4; ++m) { float* rp = Eloc + (size_t)(row0 + ai * HALF + m * 16) * 128 + col0;
#pragma unroll
                for (int n = 0; n < 2; ++n) *(f32x4*)(rp + n * 16) = acc[ai][0][m][n]; }
    }
};
struct EpiS5 {
    static constexpr bool PERM = true, AFTER_DRAIN = false;
    const bf16_t* As5; const float* dsk; bf16_t* Y;
    __device__ __forceinline__ void operator()(const f32x4 (&acc)[2][2][4][2], const Unit& u, int wr, int wc, int fr, int fq) const {
        const int g = u.pm >> 2;
        const int R0 = u.pm * BM + wr * 64 + fr;
#pragma unroll
        for (int bj = 0; bj < 2; ++bj) {
            const int col = bj * HALF + wc * 32 + 8 * fq, t = col >> 4, c0 = col & 15;
            const f32x4 d0 = *(const f32x4*)(dsk + g * 16 + c0), d1 = *(const f32x4*)(dsk + g * 16 + c0 + 4);
#pragma unroll
            for (int ai = 0; ai < 2; ++ai)
#pragma unroll
                for (int m = 0; m < 4; ++m) {
                    const int R = R0 + ai * HALF + m * 16, ch = R - g * 1024;
                    const u32x4 uw = *(const u32x4*)(As5 + (size_t)R * 384 + col);
                    f32x4 v0 = acc[ai][bj][m][0], v1 = acc[ai][bj][m][1];
                    v0[0] += d0[0] * bf_lo(uw.x); v0[1] += d0[1] * bf_hi(uw.x); v0[2] += d0[2] * bf_lo(uw.y); v0[3] += d0[3] * bf_hi(uw.y);
                    v1[0] += d1[0] * bf_lo(uw.z); v1[1] += d1[1] * bf_hi(uw.z); v1[2] += d1[2] * bf_lo(uw.w); v1[3] += d1[3] * bf_hi(uw.w);
#pragma unroll
                    for (int j = 0; j < 4; ++j) { v0[j] = gelu_tanh_f(v0[j]); v1[j] = gelu_tanh_f(v1[j]); }
                    u32x4 w; w.x = cvt_pk_bf16(v0[0], v0[1]); w.y = cvt_pk_bf16(v0[2], v0[3]); w.z = cvt_pk_bf16(v1[0], v1[1]); w.w = cvt_pk_bf16(v1[2], v1[3]);
                    *(u32x4*)(Y + (size_t)(ch * 16 + t) * 1024 + g * 16 + c0) = w;
                    if (m & 1) asm volatile("" ::: "memory");
                }
        }
    }
};
struct EpiGlu {
    static constexpr bool PERM = true, AFTER_DRAIN = false;
    const float* bias; const float* resid; float* hout; bf16_t* hb; float* ssq;
    __device__ __forceinline__ void operator()(const f32x4 (&acc)[2][2][4][2], const Unit& u, int wr, int wc, int fr, int fq) const {
        const int row0 = u.pm * BM + wr * 64 + fr, oc = u.pn * HALF + wc * 32 + 8 * fq;
        const f32x4 bv0 = *(const f32x4*)(bias + oc), bv1 = *(const f32x4*)(bias + oc + 4), bg0 = *(const f32x4*)(bias + 1024 + oc), bg1 = *(const f32x4*)(bias + 1024 + oc + 4);
#pragma unroll
        for (int ai = 0; ai < 2; ++ai)
#pragma unroll
            for (int m = 0; m < 4; ++m) {
                const int row = row0 + ai * HALF + m * 16; const size_t off = (size_t)row * 1024 + oc;
                const f32x4 r0 = *(const f32x4*)(resid + off), r1 = *(const f32x4*)(resid + off + 4);
                f32x4 h0, h1; float s = 0.f;
#pragma unroll
                for (int j = 0; j < 4; ++j) {
                    h0[j] = r0[j] + (acc[ai][0][m][0][j] + bv0[j]) * fast_sigmoid(acc[ai][1][m][0][j] + bg0[j]);
                    h1[j] = r1[j] + (acc[ai][0][m][1][j] + bv1[j]) * fast_sigmoid(acc[ai][1][m][1][j] + bg1[j]);
                    s += h0[j] * h0[j] + h1[j] * h1[j]; }
                *(f32x4*)(hout + off) = h0; *(f32x4*)(hout + off + 4) = h1;
                u32x4 w; w.x = cvt_pk_bf16(h0[0], h0[1]); w.y = cvt_pk_bf16(h0[2], h0[3]); w.z = cvt_pk_bf16(h1[0], h1[1]); w.w = cvt_pk_bf16(h1[2], h1[3]);
                *(u32x4*)(hb + off) = w;
                s += __shfl_xor(s, 16); s += __shfl_xor(s, 32);
                if (fq == 0) atomicAdd(ssq + row, s);
            }
    }
};
struct EpiMlpIn {
    static constexpr bool PERM = true, AFTER_DRAIN = false;
    const float* ssq; bf16_t* act;
    __device__ __forceinline__ void operator()(const f32x4 (&acc)[2][2][4][2], const Unit& u, int wr, int wc, int fr, int fq) const {
        const int row0 = u.pm * BM + wr * 64 + fr, col0 = u.pn * BM + wc * 32 + 8 * fq;
#pragma unroll
        for (int ai = 0; ai < 2; ++ai)
#pragma unroll
            for (int m = 0; m < 4; ++m) {
                const int row = row0 + ai * HALF + m * 16;
                const float r = rsqrtf(ssq[row] * (1.0f / 1024.0f) + RMS_EPS);
                bf16_t* rowp = act + (size_t)row * 4096 + col0;
#pragma unroll
                for (int bj = 0; bj < 2; ++bj) {
                    f32x4 v0 = acc[ai][bj][m][0] * r, v1 = acc[ai][bj][m][1] * r;
#pragma unroll
                    for (int j = 0; j < 4; ++j) { v0[j] = fmaxf(v0[j], 0.f); v0[j] *= v0[j]; v1[j] = fmaxf(v1[j], 0.f); v1[j] *= v1[j]; }
                    u32x4 w; w.x = cvt_pk_bf16(v0[0], v0[1]); w.y = cvt_pk_bf16(v0[2], v0[3]); w.z = cvt_pk_bf16(v1[0], v1[1]); w.w = cvt_pk_bf16(v1[2], v1[3]);
                    *(u32x4*)(rowp + bj * HALF) = w; }
            }
    }
};
struct EpiResid {
    static constexpr bool PERM = true, AFTER_DRAIN = false;
    float* h; const float* bias; bf16_t* hb; float* ssq;
    __device__ __forceinline__ void operator()(const f32x4 (&acc)[2][2][4][2], const Unit& u, int wr, int wc, int fr, int fq) const {
        const int row0 = u.pm * BM + wr * 64 + fr, col0 = u.pn * BM + wc * 32 + 8 * fq;
        f32x4 bv[2][2];
#pragma unroll
        for (int bj = 0; bj < 2; ++bj)
#pragma unroll
            for (int n = 0; n < 2; ++n) bv[bj][n] = bias ? *(const f32x4*)(bias + col0 + bj * HALF + 4 * n) : (f32x4){0.f, 0.f, 0.f, 0.f};
#pragma unroll
        for (int ai = 0; ai < 2; ++ai)
#pragma unroll
            for (int m = 0; m < 4; ++m) {
                const int row = row0 + ai * HALF + m * 16; float s = 0.f;
#pragma unroll
                for (int bj = 0; bj < 2; ++bj) {
                    const size_t off = (size_t)row * 1024 + col0 + bj * HALF;
                    const f32x4 h0 = *(const f32x4*)(h + off) + acc[ai][bj][m][0] + bv[bj][0], h1 = *(const f32x4*)(h + off + 4) + acc[ai][bj][m][1] + bv[bj][1];
                    *(f32x4*)(h + off) = h0; *(f32x4*)(h + off + 4) = h1;
                    if (hb) { u32x4 w; w.x = cvt_pk_bf16(h0[0], h0[1]); w.y = cvt_pk_bf16(h0[2], h0[3]); w.z = cvt_pk_bf16(h1[0], h1[1]); w.w = cvt_pk_bf16(h1[2], h1[3]); *(u32x4*)(hb + off) = w; }
#pragma unroll
                    for (int j = 0; j < 4; ++j) s += h0[j] * h0[j] + h1[j] * h1[j];
                }
                s += __shfl_xor(s, 16); s += __shfl_xor(s, 32);
                if (fq == 0) atomicAdd(ssq + row, s);
            }
    }
};
struct EpiQkv {
    static constexpr bool PERM = true, AFTER_DRAIN = false;
    const float* ssq; const float* bq; const float* bkv; bf16_t* Qb; bf16_t* KVb; float qscale;
    __device__ __forceinline__ void operator()(const f32x4 (&acc)[2][2][4][2], const Unit& u, int wr, int wc, int fr, int fq) const {
        const int row0 = u.pm * BM + wr * 64 + fr, colt = u.pn * BM, cw = wc * 32 + 8 * fq;
        const bool isq = colt < 1024;
        const float* bias = isq ? bq + colt : bkv + (colt - 1024);
        bf16_t* obase = isq ? Qb + colt : KVb + (colt - 1024);
        const int ldo = isq ? 1024 : 512; const float sc = isq ? qscale : 1.0f;
        f32x4 bv[2][2];
#pragma unroll
        for (int bj = 0; bj < 2; ++bj)
#pragma unroll
            for (int n = 0; n < 2; ++n) bv[bj][n] = *(const f32x4*)(bias + cw + bj * HALF + 4 * n);
#pragma unroll
        for (int ai = 0; ai < 2; ++ai)
#pragma unroll
            for (int m = 0; m < 4; ++m) {
                const int row = row0 + ai * HALF + m * 16;
                const float r = rsqrtf(ssq[row] * (1.0f / 1024.0f) + RMS_EPS);
                bf16_t* rowp = obase + (size_t)row * ldo + cw;
#pragma unroll
                for (int bj = 0; bj < 2; ++bj) {
                    const f32x4 v0 = (acc[ai][bj][m][0] * r + bv[bj][0]) * sc, v1 = (acc[ai][bj][m][1] * r + bv[bj][1]) * sc;
                    u32x4 w; w.x = cvt_pk_bf16(v0[0], v0[1]); w.y = cvt_pk_bf16(v0[2], v0[3]); w.z = cvt_pk_bf16(v1[0], v1[1]); w.w = cvt_pk_bf16(v1[2], v1[3]);
                    *(u32x4*)(rowp + bj * HALF) = w; }
            }
    }
};
struct S5Order {
    int G, c;
    __device__ __forceinline__ bool next(int i, Unit& u) const { const int id = i * G + c; if (id >= 256) return false; u.pm = id; u.pn = id >> 2; return true; }
    __device__ __forceinline__ void a_ready(const Unit&) const {}
    __device__ __forceinline__ void done(const Unit&) const {}
};
template <class Epi, class Sched, bool ALIGN_EPI = false, bool SP2 = false>
__device__ __forceinline__ void gemm_phase(PG8_LAS unsigned char* lds, const Gemm g, const Sched& S, const Epi& E) {
    int tid_ = threadIdx.x; asm volatile("" : "+v"(tid_));
    const int tid = tid_, wid = __builtin_amdgcn_readfirstlane(tid >> 6), lane = tid & 63, wr = wid >> 2, wc = wid & 3, fr = lane & 15, fq = lane >> 4;
    int K_ = g.K; asm volatile("" : "+s"(K_));
    const int K = K_, nt = K / BK;
    unsigned voffA[2], voffB[2];
#pragma unroll
    for (int i = 0; i < 2; ++i) { int R, C; stage_rc(tid * 16 + i * 8192, R, C); const int Rb = Epi::PERM ? ((R & ~31) + perm32(R & 31)) : R;
        voffA[i] = (unsigned)(R * g.lda + C) * 2u; voffB[i] = (unsigned)(Rb * g.ldb + C) * 2u; }
    const size_t kstep = (size_t)(BK * 2);
    const size_t hstepA = (size_t)HALF * g.lda * 2, hstepB = (size_t)HALF * g.ldb * 2;
    const size_t tstepA = 2 * hstepA, tstepB = 2 * hstepB;
    const unsigned ldsw = (unsigned)wid * 1024u;
    const int aoff = lds_byte(wr * 64 + fr, fq * 8), boff = lds_byte(wc * 32 + fr, fq * 8);
#define PG8_SA(b, h) (((b) * 2 + (h)) * HTB)
#define PG8_SB(b, h) ((4 + (b) * 2 + (h)) * HTB)
#define PG8_STAGE(bufoff, gbase, voff) do { _Pragma("unroll") for (int _i = 0; _i < 2; ++_i) \
        __builtin_amdgcn_global_load_lds((const unsigned*)((const char*)(gbase) + (voff)[_i]), (PG8_LAS unsigned*)(lds + (bufoff) + ldsw + _i * 8192), 16, 0, 0); } while (0)
#define PG8_LDA(dst, b, h) do { _Pragma("unroll") for (int m = 0; m < 4; ++m) _Pragma("unroll") for (int k = 0; k < 2; ++k) dst[m][k] = *(const PG8_LAS bf16x8*)(lds + PG8_SA(b, h) + aoff + m * 2048 + k * 1024); } while (0)
#define PG8_LDB(dst, b, h) do { _Pragma("unroll") for (int n = 0; n < 2; ++n) _Pragma("unroll") for (int k = 0; k < 2; ++k) dst[n][k] = *(const PG8_LAS bf16x8*)(lds + PG8_SB(b, h) + boff + n * 2048 + k * 1024); } while (0)
#define PG8_MMA(ai, bj, At, Bt) do { __builtin_amdgcn_s_setprio(1); _Pragma("unroll") for (int m = 0; m < 4; ++m) _Pragma("unroll") for (int n = 0; n < 2; ++n) _Pragma("unroll") for (int k = 0; k < 2; ++k) \
        acc[ai][bj][m][n] = __builtin_amdgcn_mfma_f32_16x16x32_bf16(Bt[n][k], At[m][k], acc[ai][bj][m][n], 0, 0, 0); __builtin_amdgcn_s_setprio(0); } while (0)
#define PG8_WAIT_V(n) asm volatile("s_waitcnt vmcnt(" #n ")" ::: "memory")
#define PG8_WAIT_L(n) asm volatile("s_waitcnt lgkmcnt(" #n ")" ::: "memory")
#define PG8_BAR __builtin_amdgcn_s_barrier()
#define PG8_SCHED __builtin_amdgcn_sched_barrier(0)
    Unit cur, nxt; int ui = 0;
    if (!S.next(0, cur)) return;
    f32x4 acc[2][2][4][2];
#pragma unroll
    for (int a = 0; a < 2; ++a)
#pragma unroll
        for (int b = 0; b < 2; ++b)
#pragma unroll
            for (int m = 0; m < 4; ++m)
#pragma unroll
                for (int n = 0; n < 2; ++n) acc[a][b][m][n] = (f32x4){0.f, 0.f, 0.f, 0.f};
    bf16x8 At[4][2], B0[2][2], B1[2][2];
    const char* cA = (const char*)g.A + (size_t)cur.pm * tstepA; const char* cB = (const char*)g.Bt + (size_t)cur.pn * tstepB;
    S.a_ready(cur);
    if constexpr (SP2) {
        PG8_STAGE(PG8_SB(0, 0), cB, voffB); PG8_STAGE(PG8_SB(0, 1), cB + hstepB, voffB); PG8_STAGE(PG8_SA(0, 0), cA, voffA); PG8_STAGE(PG8_SA(0, 1), cA + hstepA, voffA);
        if (wr == 1) PG8_BAR;
        PG8_WAIT_V(2); PG8_BAR;
        PG8_STAGE(PG8_SB(1, 0), cB + kstep, voffB); PG8_STAGE(PG8_SA(1, 0), cA + kstep, voffA); PG8_STAGE(PG8_SB(1, 1), cB + hstepB + kstep, voffB);
        PG8_WAIT_V(6); PG8_BAR;
    } else {
        PG8_STAGE(PG8_SB(0, 0), cB, voffB); PG8_STAGE(PG8_SA(0, 0), cA, voffA); PG8_STAGE(PG8_SB(0, 1), cB + hstepB, voffB); PG8_STAGE(PG8_SA(0, 1), cA + hstepA, voffA);
        if (wr == 1) PG8_BAR;
        PG8_WAIT_V(4); PG8_BAR;
        PG8_STAGE(PG8_SB(1, 0), cB + kstep, voffB); PG8_STAGE(PG8_SA(1, 0), cA + kstep, voffA); PG8_STAGE(PG8_SB(1, 1), cB + hstepB + kstep, voffB);
        PG8_WAIT_V(6); PG8_BAR;
    }
    for (;;) {
        const bool has_next = S.next(ui + 1, nxt);
        const char* nA = has_next ? (const char*)g.A + (size_t)nxt.pm * tstepA : cA; const char* nB = has_next ? (const char*)g.Bt + (size_t)nxt.pn * tstepB : cB;
        for (int t = 0; t < nt; t += 2) {
            const bool last = (t == nt - 2);
            const char* a1 = cA + (size_t)(t + 1) * kstep;
            const char* a2 = last ? nA : cA + (size_t)(t + 2) * kstep; const char* b2 = last ? nB : cB + (size_t)(t + 2) * kstep;
            const char* a3 = a2 + kstep; const char* b3 = b2 + kstep;
            if (last && has_next) S.a_ready(nxt);
            if constexpr (SP2) {
            PG8_LDB(B0, 0, 0); PG8_LDB(B1, 0, 1); PG8_SCHED; PG8_LDA(At, 0, 0); PG8_STAGE(PG8_SA(1, 1), a1 + hstepA, voffA);
            PG8_WAIT_V(8); PG8_WAIT_L(0); PG8_BAR; PG8_MMA(0, 0, At, B0); PG8_MMA(0, 1, At, B1); PG8_BAR; PG8_SCHED;
            PG8_LDA(At, 0, 1); PG8_STAGE(PG8_SB(0, 0), b2, voffB); PG8_STAGE(PG8_SB(0, 1), b2 + hstepB, voffB); PG8_STAGE(PG8_SA(0, 0), a2, voffA);
            PG8_WAIT_V(8); PG8_WAIT_L(0); PG8_BAR; PG8_MMA(1, 0, At, B0); PG8_MMA(1, 1, At, B1); PG8_BAR; PG8_SCHED;
            PG8_LDB(B0, 1, 0); PG8_LDB(B1, 1, 1); PG8_SCHED; PG8_LDA(At, 1, 0); PG8_STAGE(PG8_SA(0, 1), a2 + hstepA, voffA);
            PG8_WAIT_V(8); PG8_WAIT_L(0); PG8_BAR; PG8_MMA(0, 0, At, B0); PG8_MMA(0, 1, At, B1); PG8_BAR; PG8_SCHED;
            PG8_LDA(At, 1, 1); PG8_STAGE(PG8_SB(1, 0), b3, voffB); PG8_STAGE(PG8_SB(1, 1), b3 + hstepB, voffB); PG8_STAGE(PG8_SA(1, 0), a3, voffA);
            PG8_WAIT_V(8); PG8_WAIT_L(0); PG8_BAR; PG8_MMA(1, 0, At, B0); PG8_MMA(1, 1, At, B1); PG8_BAR; PG8_SCHED;
            } else {
            PG8_LDB(B0, 0, 0); PG8_SCHED; PG8_LDA(At, 0, 0); PG8_STAGE(PG8_SA(1, 1), a1 + hstepA, voffA);
            PG8_WAIT_L(8); PG8_BAR; PG8_WAIT_L(0); PG8_MMA(0, 0, At, B0); PG8_BAR; PG8_SCHED;
            PG8_LDB(B1, 0, 1); PG8_STAGE(PG8_SB(0, 0), b2, voffB);
            PG8_BAR; PG8_WAIT_L(0); PG8_MMA(0, 1, At, B1); PG8_BAR;
            PG8_LDA(At, 0, 1); PG8_STAGE(PG8_SA(0, 0), a2, voffA);
            PG8_BAR; PG8_WAIT_L(0); PG8_MMA(1, 0, At, B0); PG8_BAR; PG8_SCHED;
            PG8_STAGE(PG8_SB(0, 1), b2 + hstepB, voffB);
            PG8_WAIT_V(6); PG8_BAR; PG8_MMA(1, 1, At, B1); PG8_BAR;
            PG8_LDB(B0, 1, 0); PG8_SCHED; PG8_LDA(At, 1, 0); PG8_STAGE(PG8_SA(0, 1), a2 + hstepA, voffA);
            PG8_WAIT_L(8); PG8_BAR; PG8_WAIT_L(0); PG8_MMA(0, 0, At, B0); PG8_BAR; PG8_SCHED;
            PG8_LDB(B1, 1, 1); PG8_STAGE(PG8_SB(1, 0), b3, voffB);
            PG8_BAR; PG8_WAIT_L(0); PG8_MMA(0, 1, At, B1); PG8_BAR;
            PG8_LDA(At, 1, 1); PG8_STAGE(PG8_SA(1, 0), a3, voffA);
            PG8_BAR; PG8_WAIT_L(0); PG8_MMA(1, 0, At, B0); PG8_BAR; PG8_SCHED;
            PG8_STAGE(PG8_SB(1, 1), b3 + hstepB, voffB);
            PG8_WAIT_V(6); PG8_BAR; PG8_MMA(1, 1, At, B1); PG8_BAR;
            }
        }
        if constexpr (ALIGN_EPI) { if (wr == 0) PG8_BAR; }
        if constexpr (!Epi::AFTER_DRAIN) { int fr_e = fr, fq_e = fq; asm volatile("" : "+v"(fr_e), "+v"(fq_e));
            E(acc, cur, wr, wc, fr_e, fq_e); S.done(cur); }
        if (!has_next) break;
#pragma unroll
        for (int a = 0; a < 2; ++a)
#pragma unroll
            for (int b = 0; b < 2; ++b)
#pragma unroll
                for (int m = 0; m < 4; ++m)
#pragma unroll
                    for (int n = 0; n < 2; ++n) acc[a][b][m][n] = (f32x4){0.f, 0.f, 0.f, 0.f};
        cur = nxt; cA = nA; cB = nB; ++ui;
        if constexpr (ALIGN_EPI) { if (wr == 1) PG8_BAR; }
    }
    PG8_WAIT_V(0);
    if constexpr (!ALIGN_EPI) { if (wr == 0) PG8_BAR; }
    PG8_BAR;
    if constexpr (Epi::AFTER_DRAIN) { E.fused(acc, cur, wr, wc, fr, fq, lds, wid, lane); S.done(cur); }
#undef PG8_SA
#undef PG8_SB
#undef PG8_STAGE
#undef PG8_LDA
#undef PG8_LDB
#undef PG8_MMA
#undef PG8_WAIT_V
#undef PG8_WAIT_L
#undef PG8_BAR
#undef PG8_SCHED
}
}
namespace att {
typedef short bf16x8 __attribute__((ext_vector_type(8)));
typedef short s16x4 __attribute__((ext_vector_type(4)));
typedef float f32x16 __attribute__((ext_vector_type(16)));
typedef unsigned u32x4 __attribute__((ext_vector_type(4)));
typedef float f32x2_t __attribute__((ext_vector_type(2))); typedef __bf16 bf16x2_t __attribute__((ext_vector_type(2)));
#define ATT_LAS __attribute__((address_space(3)))
constexpr int SLOTB = 8192, LDS_K = 0, LDS_V = 4 * SLOTB, LDS_OST = 8 * SLOTB, LDS_BYTES = LDS_OST + 8 * 4096;
__device__ __forceinline__ int crow(int r, int hi) { return (r & 3) + 8 * (r >> 2) + 4 * hi; }
__device__ __forceinline__ unsigned cvtpk_s(float lo, float hi) { f32x2_t v = {lo, hi}; bf16x2_t b = __builtin_convertvector(v, bf16x2_t); return __builtin_bit_cast(unsigned, b); }
__device__ __forceinline__ s16x4 vtr(const ATT_LAS unsigned char* p) { return __builtin_bit_cast(s16x4, __builtin_amdgcn_ds_read_tr16_b64_v4i16((ATT_LAS s16x4*)p)); }

__device__ __forceinline__ void attn_unit(int b, int n, int kh, const unsigned short* Q, const unsigned short* KV, const float* sinks, unsigned short* O, ATT_LAS unsigned char* lds) {
    int tid_ = threadIdx.x; asm volatile("" : "+v"(tid_));
    const int tid = tid_, lane = tid & 63, r32 = lane & 31, hi = lane >> 5; const int wid = __builtin_amdgcn_readfirstlane(tid >> 6);
    const long tok0 = (long)b * 2048 + (long)n * 128;
#pragma unroll
    for (int i = 0; i < 4; ++i) {
        u32x4 kq = {0u, 0u, 0u, 0u}, vq = {0u, 0u, 0u, 0u};
        if (n > 0 || i >= 2) {
            const long krow = tok0 - 128 + 64 * i + lane;
            kq = *(const u32x4*)(KV + krow * 512 + kh * 64 + wid * 8);
            const long vrow = tok0 - 128 + 64 * i + 16 * (wid & 3) + (lane >> 2);
            vq = *(const u32x4*)(KV + vrow * 512 + 256 + kh * 64 + (wid >> 2) * 32 + (lane & 3) * 8);
        }
        *(ATT_LAS u32x4*)(lds + LDS_K + i * SLOTB + wid * 1024 + lane * 16) = kq;
        *(ATT_LAS u32x4*)(lds + LDS_V + i * SLOTB + wid * 1024 + lane * 16) = vq;
    }
    __syncthreads();
    const int g = wid >> 1, hq = kh * 4 + g;
    const float sink2 = sinks[hq] * 1.4426950408889634f;
    const int vlane = ((lane >> 4) & 1) * 32 + (lane & 3) * 8 + (4 * hi + ((lane & 15) >> 2)) * 64;
#pragma unroll 1
    for (int sti = 0; sti < 2; ++sti) {
        const int st = (wid & 1) * 2 + sti, q0 = 32 * st;
        const unsigned short* Qw = Q + (tok0 + q0 + r32) * 1024 + hq * 64 + hi * 8;
        bf16x8 qr[4];
#pragma unroll
        for (int d0 = 0; d0 < 4; ++d0) qr[d0] = *(const bf16x8*)(Qw + d0 * 16);
        f32x16 p[5];
#pragma unroll
        for (int i = 0; i < 5; ++i) {
            const int kt = st + i, slot = kt >> 1, half = kt & 1;
            const ATT_LAS unsigned char* kb = lds + LDS_K + slot * SLOTB + hi * 1024 + (half * 32 + r32) * 16;
            f32x16 acc = {};
#pragma unroll
            for (int d0 = 0; d0 < 4; ++d0) { const bf16x8 a = *(const ATT_LAS bf16x8*)(kb + d0 * 2048); acc = __builtin_amdgcn_mfma_f32_32x32x16_bf16(a, qr[d0], acc, 0, 0, 0); }
            p[i] = acc;
        }
        const int qi = q0 + r32;
        float mx = sink2;
#pragma unroll
        for (int i = 0; i < 5; ++i)
#pragma unroll
            for (int r = 0; r < 16; ++r) {
                const int kj = 32 * (st + i) + crow(r, hi);
                const bool valid = (kj > qi) && (kj <= qi + 128) && (n > 0 || kj >= 128);
                const float s = valid ? p[i][r] : -__builtin_inff();
                p[i][r] = s; mx = fmaxf(mx, s);
            }
        mx = fmaxf(mx, __shfl_xor(mx, 32));
        float sum = 0.f;
#pragma unroll
        for (int i = 0; i < 5; ++i)
#pragma unroll
            for (int r = 0; r < 16; ++r) { const float e = __builtin_amdgcn_exp2f(p[i][r] - mx); p[i][r] = e; sum += e; }
        sum += __shfl_xor(sum, 32);
        const float inv = 1.0f / (sum + __builtin_amdgcn_exp2f(sink2 - mx));
        f32x16 o[2]; o[0] = f32x16{}; o[1] = f32x16{};
#pragma unroll
        for (int i = 0; i < 5; ++i) {
            const int kt = st + i, slot = kt >> 1, half = kt & 1;
            u32x4 plo, phi;
            plo.x = cvtpk_s(p[i][0] * inv, p[i][1] * inv); plo.y = cvtpk_s(p[i][2] * inv, p[i][3] * inv); plo.z = cvtpk_s(p[i][4] * inv, p[i][5] * inv); plo.w = cvtpk_s(p[i][6] * inv, p[i][7] * inv);
            phi.x = cvtpk_s(p[i][8] * inv, p[i][9] * inv); phi.y = cvtpk_s(p[i][10] * inv, p[i][11] * inv); phi.z = cvtpk_s(p[i][12] * inv, p[i][13] * inv); phi.w = cvtpk_s(p[i][14] * inv, p[i][15] * inv);
            const bf16x8 pa_lo = __builtin_bit_cast(bf16x8, plo), pa_hi = __builtin_bit_cast(bf16x8, phi);
            const ATT_LAS unsigned char* vb = lds + LDS_V + slot * SLOTB + vlane;
#pragma unroll
            for (int d0 = 0; d0 < 2; ++d0) {
                const s16x4 l0 = vtr(vb + d0 * 4096 + (2 * half) * 1024), h0 = vtr(vb + d0 * 4096 + (2 * half) * 1024 + 512);
                const s16x4 l1 = vtr(vb + d0 * 4096 + (2 * half + 1) * 1024), h1 = vtr(vb + d0 * 4096 + (2 * half + 1) * 1024 + 512);
                const bf16x8 v0 = (bf16x8){l0[0], l0[1], l0[2], l0[3], h0[0], h0[1], h0[2], h0[3]};
                const bf16x8 v1 = (bf16x8){l1[0], l1[1], l1[2], l1[3], h1[0], h1[1], h1[2], h1[3]};
                o[d0] = __builtin_amdgcn_mfma_f32_32x32x16_bf16(pa_lo, v0, o[d0], 0, 0, 0);
                o[d0] = __builtin_amdgcn_mfma_f32_32x32x16_bf16(pa_hi, v1, o[d0], 0, 0, 0);
            }
        }
        ATT_LAS unsigned short* stg = (ATT_LAS unsigned short*)(lds + LDS_OST + wid * 4096);
#pragma unroll
        for (int r = 0; r < 16; ++r) {
            const int orow = crow(r, hi);
#pragma unroll
            for (int d0 = 0; d0 < 2; ++d0) stg[orow * 64 + d0 * 32 + r32] = (unsigned short)(cvtpk_s(o[d0][r], 0.f) & 0xffffu);
        }
        asm volatile("s_waitcnt lgkmcnt(0)" ::: "memory");
        unsigned short* Ow = O + (tok0 + q0) * 1024 + hq * 64;
#pragma unroll
        for (int i = 0; i < 4; ++i) { const int row = i * 8 + (lane >> 3), ch = lane & 7; const u32x4 v = *(const ATT_LAS u32x4*)(stg + row * 64 + ch * 8); *(u32x4*)(Ow + (long)row * 1024 + ch * 8) = v; }
        asm volatile("s_waitcnt lgkmcnt(0)" ::: "memory");
    }
    __syncthreads();
}
#undef ATT_LAS
}
#define GAS __attribute__((address_space(1)))
#define LAS __attribute__((address_space(3)))
typedef unsigned short bf16;
typedef unsigned v4u __attribute__((ext_vector_type(4)));
typedef float f32x4 __attribute__((ext_vector_type(4)));
typedef short bf16x8 __attribute__((ext_vector_type(8)));
typedef GAS unsigned gu32;
typedef GAS unsigned long long gu64;
#define RLX_AGENT __ATOMIC_RELAXED, __HIP_MEMORY_SCOPE_AGENT
#define LDS_WAIT() asm volatile("s_waitcnt lgkmcnt(0)" ::: "memory")
#define VM_WAIT() asm volatile("s_waitcnt vmcnt(0)" ::: "memory")
__device__ __forceinline__ unsigned long long rt() { return __builtin_amdgcn_s_memrealtime(); }
__device__ __forceinline__ unsigned f2bf(float f) { unsigned u = __builtin_bit_cast(unsigned, f); return (u + 0x7fffu + ((u >> 16) & 1u)) >> 16; }
__device__ __forceinline__ unsigned pk2(float lo, float hi) { return f2bf(lo) | (f2bf(hi) << 16); }

#define XB_TMO      128
#define XB_XCNT(j)  (256  + 64 * (j))
#define XB_XSUB(j)  (1280 + 64 * (j))
#define XB_XGEN(j)  (2304 + 64 * (j))
#define XB_TOP      3328
#define XB_TOPGEN   3392
#define XCD_BAR_WORDS 3456
#define XB_SPIN_CAP (1u << 18)

__device__ __forceinline__ unsigned xb_ld(unsigned* p)              { return __hip_atomic_load(p, __ATOMIC_RELAXED, __HIP_MEMORY_SCOPE_AGENT); }
__device__ __forceinline__ unsigned xb_add(unsigned* p, unsigned v) { return __hip_atomic_fetch_add(p, v, __ATOMIC_RELAXED, __HIP_MEMORY_SCOPE_AGENT); }
__device__ __forceinline__ unsigned xb_xcc_id() { return (unsigned)__builtin_amdgcn_s_getreg((3 << 11) | 20) & 0xFu; }
#define XB_SPIN(cond, bar) do { unsigned _sp = 0; while (cond) { __builtin_amdgcn_s_sleep(1); \
    if ((++_sp & 255u) == 0u) { if (xb_ld(&(bar)[XB_TMO])) break; if (_sp > XB_SPIN_CAP) { atomicAdd(&(bar)[XB_TMO], 1u); break; } } } } while (0)

struct XcdBarrier {
    unsigned* bar; unsigned x;
    volatile LAS unsigned* st;
};

__device__ __forceinline__ XcdBarrier xcd_barrier_post(unsigned* bar, volatile LAS unsigned* st) {
    XcdBarrier b; b.bar = bar; b.x = xb_xcc_id(); b.st = st;
    if (threadIdx.x == 0) (void)xb_add(&bar[XB_XCNT(b.x)], 1u);
    return b;
}
__device__ __forceinline__ void xcd_barrier_complete(unsigned* bar, unsigned x, unsigned& nloc, unsigned& nx) {
    const unsigned G = gridDim.x * gridDim.y * gridDim.z;
    unsigned sum, cnt, mine, sp = 0u;
    for (;;) {
        sum = 0u; cnt = 0u; mine = 0u;
#pragma unroll
        for (unsigned j = 0; j < 16; ++j) { const unsigned c = xb_ld(&bar[XB_XCNT(j)]); sum += c; cnt += (c > 0u) ? 1u : 0u; mine = (j == x) ? c : mine; }
        if (sum == G) break;
        __builtin_amdgcn_s_sleep(1);
        if ((++sp & 255u) == 0u) { if (xb_ld(&bar[XB_TMO])) break; if (sp > XB_SPIN_CAP) { atomicAdd(&bar[XB_TMO], 1u); break; } }
    }
    nloc = mine > 0u ? mine : 1u; nx = cnt > 0u ? cnt : 1u;
}

__device__ __forceinline__ void xcd_barrier(const XcdBarrier& b) {
    asm volatile("s_waitcnt vmcnt(0)" ::: "memory");
    __syncthreads();
    if (threadIdx.x == 0) {
        unsigned* bar = b.bar;
        __builtin_amdgcn_s_waitcnt(0);
        unsigned nloc = b.st[0], nx = b.st[1];
        if (nloc == 0u) { xcd_barrier_complete(bar, b.x, nloc, nx); b.st[0] = nloc; b.st[1] = nx; }
        const unsigned old = xb_add(&bar[XB_XSUB(b.x)], 1u);
        const unsigned gen = old / nloc;
        if (old + 1u == (gen + 1u) * nloc) {
            __builtin_amdgcn_fence(__ATOMIC_RELEASE, "agent");
            asm volatile("s_waitcnt vmcnt(0)" ::: "memory");
            const unsigned og = xb_add(&bar[XB_TOP], 1u);
            const unsigned tg = og / nx;
            if (og + 1u == (tg + 1u) * nx) xb_add(&bar[XB_TOPGEN], 1u);
            else XB_SPIN(xb_ld(&bar[XB_TOPGEN]) == tg, bar);
            __builtin_amdgcn_fence(__ATOMIC_ACQUIRE, "agent");
            xb_add(&bar[XB_XGEN(b.x)], 1u);
            asm volatile("s_waitcnt vmcnt(0)" ::: "memory");
        } else {
            XB_SPIN(xb_ld(&bar[XB_XGEN(b.x)]) == gen, bar);
            __builtin_amdgcn_fence(__ATOMIC_ACQUIRE, "agent");
            asm volatile("s_waitcnt vmcnt(0)" ::: "memory");
        }
    }
    __syncthreads();
}
constexpr int NWAVES = 8;
constexpr int NB = 8, SEQ = 2048, D = 1024, FF = 4096, M = NB * SEQ, NG = 64, NP = 64, TC = 16  , NCH = M / TC  ;
constexpr int S5K = 384;
constexpr float QSCALE = 0.125f * 1.4426950408889634f;
constexpr size_t MiB = 1u << 20;
constexpr size_t WS_CTL = 0, CTL_ZERO_BYTES = 1 * MiB;
constexpr size_t WS_WGLU = 1 * MiB;
constexpr size_t WS_WIN = 5 * MiB;
constexpr size_t WS_WOUT = 21 * MiB;
constexpr size_t WS_WQKV = 37 * MiB;
constexpr size_t WS_WO = 40 * MiB;
constexpr size_t WS_BTM = 42 * MiB;
constexpr size_t WS_BTO = 54 * MiB;
constexpr size_t WS_LAMT = 62 * MiB;
constexpr size_t WS_SSQ = 62 * MiB + 64 * 1024;
constexpr size_t WS_HB = 63 * MiB;
constexpr size_t WS_R = 95 * MiB;
constexpr size_t WS_AS5 = WS_R, WS_ELOC = WS_R + 48 * MiB, WS_Y = WS_R + 80 * MiB;
constexpr size_t WS_Q = WS_R, WS_KV = WS_R + 32 * MiB, WS_O = WS_R + 48 * MiB, WS_ACT = WS_R;
constexpr size_t WS_END = WS_R + 128 * MiB;
static_assert(WS_END <= 256 * MiB, "d_ws map");
constexpr int CW_BAR = 4096;
constexpr int RING_OFF = 0, RING_BYTES = 131072;
constexpr int LDSCTL_OFF = RING_BYTES, MISC_OFF = LDSCTL_OFF + 320;
constexpr int LDS_BYTES = 147456;
static_assert(MISC_OFF + 128 <= LDS_BYTES, "LDS map");

struct Frame {
    LAS unsigned char* lds;
    volatile LAS unsigned* MISC;
    int tid, lane, wave, vcu, G;
};

__device__ __forceinline__ float wave_sum(float v) {
#pragma unroll
    for (int o = 1; o < 64; o <<= 1) v += __shfl_xor(v, o);
    return v;
}
__device__ __forceinline__ void p0_transpose_item(const float* W, int K, int ldw, const float* kscale, bf16* WT, int dst_row0, int k0, int n0, LAS float* scr, int lane) {
#pragma unroll 8
    for (int i = 0; i < 32; ++i) { const int kk = 2 * i + (lane >> 5); float w = W[(size_t)(k0 + kk) * ldw + n0 + (lane & 31)]; if (kscale) w *= kscale[k0 + kk]; scr[kk * 33 + (lane & 31)] = w; }
    LDS_WAIT(); asm volatile("" ::: "memory");
    const int c = lane & 7;
#pragma unroll
    for (int j = 0; j < 4; ++j) { const int n = (lane >> 3) + 8 * j; const LAS float* s = scr + (8 * c) * 33 + n;
        v4u o; o.x = pk2(s[0 * 33], s[1 * 33]); o.y = pk2(s[2 * 33], s[3 * 33]); o.z = pk2(s[4 * 33], s[5 * 33]); o.w = pk2(s[6 * 33], s[7 * 33]);
        *(GAS v4u*)(WT + (size_t)(dst_row0 + n) * K + k0 + 8 * c) = o; }
    LDS_WAIT(); asm volatile("" ::: "memory");
}
struct Ins {
    const float *x, *norm_mix, *norm_mlp, *norm_kv, *norm_final, *a_re, *a_im, *log_dt, *b_re, *b_im, *c_re, *c_im, *dsk, *w_glu, *b_glu, *w_kv, *b_kv, *w_q, *b_q, *sinks, *w_o, *b_o, *w_in, *w_out;
};
__device__ __forceinline__ void p0_s5_gen(Frame& F, const Ins& I, unsigned char* ws, int g, int q) {
    LAS float* PWR = (LAS float*)(F.lds);
    LAS float* PWI = PWR + 17 * 64;
    LAS float* BBR = PWI + 17 * 64;
    LAS float* BBI = BBR + 1024;
    LAS float* CR = BBI + 1024;
    LAS float* CI = CR + 1024;
    LAS float* KT = CI + 1024;
    const int tid = F.tid;
    if (tid < 64) {
        const int p = tid;
        const float lre = fminf(I.a_re[g * 64 + p], -1e-4f), lim = I.a_im[g * 64 + p];
        const float dt = expf(I.log_dt[g]);
        const float a = lre * dt, th = lim * dt;
        const float er = expf(a), cs = cosf(th), sn = sinf(th);
        const float lbr = er * cs, lbi = er * sn;
        const float sh = sinf(0.5f * th);
        const float nr = expm1f(a) * cs - 2.0f * sh * sh, ni = lbi;
        const float den = lre * lre + lim * lim;
        const float cr = (nr * lre + ni * lim) / den, ci = (ni * lre - nr * lim) / den;
        float pr = 1.f, pi = 0.f;
#pragma unroll 1
        for (int t = 0; t <= 16; ++t) { PWR[t * 64 + p] = pr; PWI[t * 64 + p] = pi; const float nr2 = pr * lbr - pi * lbi, ni2 = pr * lbi + pi * lbr; pr = nr2; pi = ni2; }
#pragma unroll
        for (int c = 0; c < 16; ++c) { const float br = I.b_re[(size_t)(g * 64 + p) * 16 + c], bi = I.b_im[(size_t)(g * 64 + p) * 16 + c]; BBR[p * 16 + c] = cr * br - ci * bi; BBI[p * 16 + c] = cr * bi + ci * br; }
    }
    for (int i = tid; i < 1024; i += NWAVES * 64) { CR[i] = I.c_re[(size_t)g * 1024 + i]; CI[i] = I.c_im[(size_t)g * 1024 + i]; }
    LDS_WAIT(); __syncthreads();
    if (q == 0 && tid < 64) { float* lt = (float*)(ws + WS_LAMT) + (size_t)(g * 64 + tid) * 2; lt[0] = PWR[16 * 64 + tid]; lt[1] = PWI[16 * 64 + tid]; }
#pragma unroll 1
    for (int j = 0; j < 8; ++j) {
        const int idx = tid + 512 * j, tau = idx >> 8, c = (idx >> 4) & 15, cp = idx & 15;
        float s = 0.f;
#pragma unroll 4
        for (int p = 0; p < 64; ++p) {
            const float pwr = PWR[tau * 64 + p], pwi = PWI[tau * 64 + p], bbr = BBR[p * 16 + cp], bbi = BBI[p * 16 + cp];
            const float wr = pwr * bbr - pwi * bbi, wi = pwr * bbi + pwi * bbr;
            s += CR[c * 64 + p] * wr - CI[c * 64 + p] * wi;
        }
        KT[idx] = s;
    }
    LDS_WAIT(); __syncthreads();
    bf16* BTM = (bf16*)(ws + WS_BTM); bf16* BTO = (bf16*)(ws + WS_BTO);
#pragma unroll 1
    for (int j = 0; j < 24; ++j) {
        const int idx = tid + 512 * j, rr = idx / 192, cpair = idx % 192, col = 2 * cpair, row = 64 * q + rr, t = row >> 4, c = row & 15;
        float v0, v1;
        if (col < 256) { const int s = col >> 4, cp = col & 15; v0 = (s <= t) ? KT[(t - s) * 256 + c * 16 + cp] : 0.f; v1 = (s <= t) ? KT[(t - s) * 256 + c * 16 + cp + 1] : 0.f; }
        else { const int p = (col - 256) >> 1; const float wr = PWR[(t + 1) * 64 + p], wi = PWI[(t + 1) * 64 + p], cr = CR[c * 64 + p], ci = CI[c * 64 + p]; v0 = cr * wr - ci * wi; v1 = -(cr * wi + ci * wr); }
        *(GAS unsigned*)(BTM + ((size_t)(g * 256 + row) * S5K + col)) = pk2(v0, v1);
    }
#pragma unroll 1
    for (int j = 0; j < 16; ++j) {
        const int idx = tid + 512 * j, rr = idx >> 7, cpair = idx & 127, col = 2 * cpair, row = 64 * q + rr;
        float v0 = 0.f, v1 = 0.f;
        if (row < 128) { const int p = row >> 1, ri = row & 1, s = col >> 4, cp = col & 15; const float pwr = PWR[(15 - s) * 64 + p], pwi = PWI[(15 - s) * 64 + p];
            const float b0r = BBR[p * 16 + cp], b0i = BBI[p * 16 + cp], b1r = BBR[p * 16 + cp + 1], b1i = BBI[p * 16 + cp + 1];
            v0 = ri ? (pwr * b0i + pwi * b0r) : (pwr * b0r - pwi * b0i); v1 = ri ? (pwr * b1i + pwi * b1r) : (pwr * b1r - pwi * b1i); }
        *(GAS unsigned*)(BTO + ((size_t)(g * 256 + row) * 256 + col)) = pk2(v0, v1);
    }
    LDS_WAIT(); __syncthreads();
}
__device__ __forceinline__ void p0_norm_chunk(Frame& F, const Ins& I, unsigned char* ws, int cidx) {
    LAS unsigned short* STG = (LAS unsigned short*)F.lds;
#pragma unroll
    for (int rr = 0; rr < 2; ++rr) {
        const int s = F.wave * 2 + rr; const size_t row = (size_t)cidx * 16 + s;
        const GAS f32x4* xr = (const GAS f32x4*)(I.x + row * D) + F.lane;
        f32x4 v[4]; float ss = 0.f;
#pragma unroll
        for (int j = 0; j < 4; ++j) { v[j] = xr[64 * j]; ss += (v[j].x * v[j].x + v[j].y * v[j].y) + (v[j].z * v[j].z + v[j].w * v[j].w); }
        const float r = rsqrtf(wave_sum(ss) * (1.f / D) + 1e-5f);
#pragma unroll
        for (int j = 0; j < 4; ++j) { const f32x4 gg = ((const GAS f32x4*)I.norm_mix)[F.lane + 64 * j];
            const unsigned lo = pk2(v[j].x * r * gg.x, v[j].y * r * gg.y), hi = pk2(v[j].z * r * gg.z, v[j].w * r * gg.w);
            *(LAS unsigned long long*)(STG + s * 1024 + 256 * j + 4 * F.lane) = (unsigned long long)lo | ((unsigned long long)hi << 32); }
    }
    LDS_WAIT(); __syncthreads();
    bf16* AS5 = (bf16*)(ws + WS_AS5);
#pragma unroll
    for (int i = 0; i < 4; ++i) {
        const int piece = F.tid + 512 * i, g = piece >> 5, within = piece & 31, s = within >> 1, hf = within & 1;
        const v4u val = *(const LAS v4u*)(STG + s * 1024 + g * 16 + 8 * hf);
        *(GAS v4u*)(AS5 + ((size_t)(g * NCH + cidx) * S5K + s * 16 + 8 * hf)) = val;
    }
    LDS_WAIT(); __syncthreads();
}
__device__ __forceinline__ int glu_row0(int n0) { return n0 < 1024 ? 256 * (n0 >> 7) + (n0 & 127) : 256 * ((n0 - 1024) >> 7) + 128 + ((n0 - 1024) & 127); }
__device__ __forceinline__ void p0_prologue(Frame& F, const Ins& I, unsigned char* ws) {
    { float* ssq = (float*)(ws + WS_SSQ); for (int i = blockIdx.x * (NWAVES * 64) + F.tid; i < 4 * M; i += F.G * NWAVES * 64) ssq[i] = 0.f; }
    for (int id = blockIdx.x; id < 256; id += F.G) p0_s5_gen(F, I, ws, id >> 2, id & 3);
    for (int c = blockIdx.x; c < NCH; c += F.G) p0_norm_chunk(F, I, ws, c);
    LAS float* scr = (LAS float*)(F.lds + F.wave * 16384);
    const int gw = F.vcu * NWAVES + F.wave, NGW = F.G * NWAVES;
    constexpr int I_GLU = 16 * 64, I_IN = 16 * 128, I_OUT = 64 * 32, I_Q = 16 * 32, I_KV = 16 * 16, I_O = 16 * 32;
    constexpr int NITEMS = I_GLU + 2 * I_IN + 2 * I_OUT + I_Q + I_KV + I_O;
    for (int it = gw; it < NITEMS; it += NGW) {
        int r = it;
        if (r < I_GLU) { const int kb = r / 64, nb = r % 64; p0_transpose_item(I.w_glu, D, 2048, nullptr, (bf16*)(ws + WS_WGLU), glu_row0(32 * nb), 64 * kb, 32 * nb, scr, F.lane); continue; } r -= I_GLU;
        if (r < 2 * I_IN) { const int l = r / I_IN, rr = r % I_IN, kb = rr / 128, nb = rr % 128;
            p0_transpose_item(I.w_in + (size_t)l * D * FF, D, FF, I.norm_mlp + l * D, (bf16*)(ws + WS_WIN) + (size_t)l * FF * D, 32 * nb, 64 * kb, 32 * nb, scr, F.lane); continue; } r -= 2 * I_IN;
        if (r < 2 * I_OUT) { const int l = r / I_OUT, rr = r % I_OUT, kb = rr / 32, nb = rr % 32;
            p0_transpose_item(I.w_out + (size_t)l * FF * D, FF, D, nullptr, (bf16*)(ws + WS_WOUT) + (size_t)l * D * FF, 32 * nb, 64 * kb, 32 * nb, scr, F.lane); continue; } r -= 2 * I_OUT;
        if (r < I_Q) { const int kb = r / 32, nb = r % 32; p0_transpose_item(I.w_q, D, D, I.norm_mix + D, (bf16*)(ws + WS_WQKV), 32 * nb, 64 * kb, 32 * nb, scr, F.lane); continue; } r -= I_Q;
        if (r < I_KV) { const int kb = r / 16, nb = r % 16; p0_transpose_item(I.w_kv, D, 512, I.norm_kv, (bf16*)(ws + WS_WQKV), 1024 + 32 * nb, 64 * kb, 32 * nb, scr, F.lane); continue; } r -= I_KV;
        { const int kb = r / 32, nb = r % 32; p0_transpose_item(I.w_o, D, D, nullptr, (bf16*)(ws + WS_WO), 32 * nb, 64 * kb, 32 * nb, scr, F.lane); }
    }
}
__device__ __forceinline__ void p2_scan_unit(Frame& F, unsigned char* ws, int g, int b) {
    const int p = F.lane, seg = F.wave;
    LAS float* ET = (LAS float*)F.lds;
    const float* lt = (const float*)(ws + WS_LAMT) + (size_t)(g * 64 + p) * 2;
    const float ar = lt[0], ai = lt[1];
    const float* el = (const float*)(ws + WS_ELOC) + ((size_t)(g * NCH + b * 128 + seg * 16)) * 128 + 2 * p;
    float er[16], ei[16];
#pragma unroll
    for (int i = 0; i < 16; ++i) { const float2 e = *(const float2*)(el + (size_t)i * 128); er[i] = e.x; ei[i] = e.y; }
    float xr = 0.f, xi = 0.f;
#pragma unroll
    for (int i = 0; i < 16; ++i) { const float nr = ar * xr - ai * xi + er[i], ni = ar * xi + ai * xr + ei[i]; er[i] = xr; ei[i] = xi; xr = nr; xi = ni; }
    ET[(seg * 64 + p) * 2] = xr; ET[(seg * 64 + p) * 2 + 1] = xi;
    float a16r = ar, a16i = ai;
#pragma unroll
    for (int k = 0; k < 4; ++k) { const float nr = a16r * a16r - a16i * a16i, ni = 2.f * a16r * a16i; a16r = nr; a16i = ni; }
    LDS_WAIT(); __syncthreads();
    float sr = 0.f, si = 0.f;
    for (int s = 0; s < seg; ++s) { const float tr = ET[(s * 64 + p) * 2], ti = ET[(s * 64 + p) * 2 + 1]; const float nr = a16r * sr - a16i * si + tr, ni = a16r * si + a16i * sr + ti; sr = nr; si = ni; }
    bf16* dst = (bf16*)(ws + WS_AS5) + ((size_t)(g * NCH + b * 128 + seg * 16)) * S5K + 256 + 2 * p;
#pragma unroll
    for (int i = 0; i < 16; ++i) {
        *(GAS unsigned*)(dst + (size_t)i * S5K) = pk2(er[i] + sr, ei[i] + si);
        const float nr = ar * sr - ai * si, ni = ar * si + ai * sr; sr = nr; si = ni;
    }
    LDS_WAIT(); __syncthreads();
}
__device__ __forceinline__ void p12_final(Frame& F, const Ins& I, unsigned char* ws, float* out) {
    const float* ssq = (const float*)(ws + WS_SSQ) + 3 * (size_t)M;
    const int gw = blockIdx.x * NWAVES + F.wave, NGW = F.G * NWAVES;
    for (int m = gw; m < M; m += NGW) {
        const float r = rsqrtf(ssq[m] * (1.f / D) + 1e-5f);
        GAS f32x4* o = (GAS f32x4*)(out + (size_t)m * D) + F.lane;
#pragma unroll
        for (int j = 0; j < 4; ++j) { const f32x4 gg = ((const GAS f32x4*)I.norm_final)[F.lane + 64 * j]; f32x4 v = o[64 * j]; v = v * r * gg; o[64 * j] = v; }
    }
}

struct Args { const float* in[24]; float* out; unsigned char* ws; int ph_lo, ph_hi; };
constexpr int N_PHASES = 13;
__global__ void __launch_bounds__(NWAVES * 64, 2) yoco_fwd(Args args) {
    extern __shared__ __attribute__((aligned(16))) unsigned char lds[];
    Frame F;
    F.lds = (LAS unsigned char*)lds;
    F.MISC = (volatile LAS unsigned*)(F.lds + MISC_OFF);
    F.tid = threadIdx.x; F.lane = F.tid & 63; F.wave = __builtin_amdgcn_readfirstlane(F.tid >> 6);
    F.G = gridDim.x; { const int bx = blockIdx.x; F.vcu = (F.G % 8 == 0) ? (bx % 8) * (F.G / 8) + bx / 8 : bx; }
    unsigned char* ws = args.ws;
    Ins I; { const float* const* a = args.in; I.x = a[0]; I.norm_mix = a[1]; I.norm_mlp = a[2]; I.norm_kv = a[3]; I.norm_final = a[4]; I.a_re = a[5]; I.a_im = a[6]; I.log_dt = a[7]; I.b_re = a[8]; I.b_im = a[9];
        I.c_re = a[10]; I.c_im = a[11]; I.dsk = a[12]; I.w_glu = a[13]; I.b_glu = a[14]; I.w_kv = a[15]; I.b_kv = a[16]; I.w_q = a[17]; I.b_q = a[18]; I.sinks = a[19]; I.w_o = a[20]; I.b_o = a[21]; I.w_in = a[22]; I.w_out = a[23]; }
    for (int u = F.tid; u < (LDS_BYTES - LDSCTL_OFF) / 4; u += NWAVES * 64) ((LAS unsigned*)(F.lds + LDSCTL_OFF))[u] = 0u;
    __syncthreads();
    const int lo = args.ph_lo, hi = args.ph_hi;
    const bool multi = (hi - lo) > 1;
    XcdBarrier bar; bar.bar = (unsigned*)(ws + WS_CTL) + CW_BAR; bar.x = 0; bar.st = nullptr;
    if (multi) bar = xcd_barrier_post((unsigned*)(ws + WS_CTL) + CW_BAR, F.MISC + 8);
#ifndef PHM
#define PHM 0xffff
#endif
#define IN(k) ((((PHM) >> (k)) & 1) && lo <= (k) && (k) < hi)
#define SEAM(k) do { if (IN(k) && IN((k) + 1)) xcd_barrier(bar); } while (0)
    float* hres = args.out;
    bf16* HB = (bf16*)(ws + WS_HB); float* SSQ = (float*)(ws + WS_SSQ);
    const int cblk = (int)blockIdx.x;

    if (IN(0)) { p0_prologue(F, I, ws); } SEAM(0);
    if (IN(1)) {
        pg8::Gemm g{(const bf16*)(ws + WS_AS5), (const bf16*)(ws + WS_BTO), NG * NCH, NG * 256, 256, S5K, 256}; pg8::S5Order S{F.G, cblk};
        pg8::EpiCarryOut E{(float*)(ws + WS_ELOC)};
        pg8::gemm_phase<pg8::EpiCarryOut, pg8::S5Order, false, true>(F.lds + RING_OFF, g, S, E);
    } SEAM(1);
    if (IN(2)) { for (int id = cblk; id < NG * NB; id += F.G) p2_scan_unit(F, ws, id >> 3, id & 7); } SEAM(2);
    if (IN(3)) {
        pg8::Gemm g{(const bf16*)(ws + WS_AS5), (const bf16*)(ws + WS_BTM), NG * NCH, NG * 256, S5K, S5K, S5K}; pg8::S5Order S{F.G, cblk};
        pg8::EpiS5 E{(const bf16*)(ws + WS_AS5), I.dsk, (bf16*)(ws + WS_Y)};
        pg8::gemm_phase<pg8::EpiS5, pg8::S5Order, false, true>(F.lds + RING_OFF, g, S, E);
    } SEAM(3);
    if (IN(4)) {
        pg8::Gemm g{(const bf16*)(ws + WS_Y), (const bf16*)(ws + WS_WGLU), M, 2048, D, D, D}; pg8::StaticOrder S; S.init(M, 2048, F.G, cblk);
        pg8::EpiGlu E{I.b_glu, I.x, hres, HB, SSQ};
        pg8::gemm_phase<pg8::EpiGlu, pg8::StaticOrder, true, true>(F.lds + RING_OFF, g, S, E);
    } SEAM(4);
    for (int layer = 0; layer < 2; ++layer) {
        const int pb = layer == 0 ? 5 : 10;
        if (IN(pb)) {
            pg8::Gemm g{HB, (const bf16*)(ws + WS_WIN) + (size_t)layer * FF * D, M, FF, D, D, D}; pg8::StaticOrder S; S.init(M, FF, F.G, cblk);
            pg8::EpiMlpIn E{SSQ + (size_t)(layer == 0 ? 0 : 2) * M, (bf16*)(ws + WS_ACT)};
            pg8::gemm_phase<pg8::EpiMlpIn, pg8::StaticOrder, true, true>(F.lds + RING_OFF, g, S, E);
        } SEAM(pb);
        if (IN(pb + 1)) {
            pg8::Gemm g{(const bf16*)(ws + WS_ACT), (const bf16*)(ws + WS_WOUT) + (size_t)layer * D * FF, M, D, FF, FF, FF}; pg8::StaticOrder S; S.init(M, D, F.G, cblk);
            pg8::EpiResid E{hres, nullptr, layer == 0 ? HB : nullptr, SSQ + (size_t)(layer == 0 ? 1 : 3) * M};
            pg8::gemm_phase<pg8::EpiResid, pg8::StaticOrder, true, true>(F.lds + RING_OFF, g, S, E);
        } SEAM(pb + 1);
        if (layer == 0) {
            if (IN(7)) {
                pg8::Gemm g{HB, (const bf16*)(ws + WS_WQKV), M, 1536, D, D, D}; pg8::StaticOrder S; S.init(M, 1536, F.G, cblk);
                pg8::EpiQkv E{SSQ + (size_t)M, I.b_q, I.b_kv, (bf16*)(ws + WS_Q), (bf16*)(ws + WS_KV), QSCALE};
                pg8::gemm_phase<pg8::EpiQkv, pg8::StaticOrder, true, true>(F.lds + RING_OFF, g, S, E);
            } SEAM(7);
            if (IN(8)) {
                for (int id = F.vcu; id < NB * 16 * 4; id += F.G) { const int kh = id & 3, n = (id >> 2) & 15, b = id >> 6;
                    att::attn_unit(b, n, kh, (const bf16*)(ws + WS_Q), (const bf16*)(ws + WS_KV), I.sinks, (bf16*)(ws + WS_O), F.lds + RING_OFF); }
            } SEAM(8);
            if (IN(9)) {
                pg8::Gemm g{(const bf16*)(ws + WS_O), (const bf16*)(ws + WS_WO), M, D, D, D, D}; pg8::StaticOrder S; S.init(M, D, F.G, cblk);
                pg8::EpiResid E{hres, I.b_o, HB, SSQ + (size_t)2 * M};
                pg8::gemm_phase<pg8::EpiResid, pg8::StaticOrder, true, true>(F.lds + RING_OFF, g, S, E);
            } SEAM(9);
        }
    }
    if (IN(12)) p12_final(F, I, ws, hres);
#undef IN
#undef SEAM
}

#ifndef MK_PER_PHASE
#define MK_PER_PHASE 0
#endif
static void fast_forward(void* const* d_in, float* d_out, unsigned char* d_ws, hipStream_t stream, int ph_lo, int ph_hi, bool per_phase) {
    static int grid = 0;
    if (grid == 0) {
        int dev = 0, cus = 0, per_cu = 0;
        if (hipGetDevice(&dev) != hipSuccess || hipDeviceGetAttribute(&cus, hipDeviceAttributeMultiprocessorCount, dev) != hipSuccess) { fprintf(stderr, "kernel_launch: device query failed\n"); grid = -1; return; }
        if (hipFuncSetAttribute((const void*)yoco_fwd, hipFuncAttributeMaxDynamicSharedMemorySize, LDS_BYTES) != hipSuccess) { fprintf(stderr, "kernel_launch: hipFuncSetAttribute failed\n"); grid = -1; return; }
        if (hipOccupancyMaxActiveBlocksPerMultiprocessor(&per_cu, (const void*)yoco_fwd, NWAVES * 64, LDS_BYTES) != hipSuccess || per_cu < 1) { fprintf(stderr, "kernel_launch: occupancy query reports %d workgroups per CU\n", per_cu); }
        (void)hipGetLastError();
        grid = cus;
    }
    if (grid < 0) return;
    (void)hipMemsetAsync(d_ws + WS_CTL, 0, CTL_ZERO_BYTES, stream);
    Args a{};
    for (int i = 0; i < 24; ++i) a.in[i] = (const float*)d_in[i];
    a.out = d_out; a.ws = d_ws;
    if (per_phase) { for (int p = ph_lo; p < ph_hi; ++p) { a.ph_lo = p; a.ph_hi = p + 1; hipLaunchKernelGGL(yoco_fwd, dim3(grid), dim3(NWAVES * 64), LDS_BYTES, stream, a); } }
    else { a.ph_lo = ph_lo; a.ph_hi = ph_hi; hipLaunchKernelGGL(yoco_fwd, dim3(grid), dim3(NWAVES * 64), LDS_BYTES, stream, a); }
    const hipError_t le = hipPeekAtLastError();
    if (le != hipSuccess) fprintf(stderr, "kernel_launch: launch failed: %s\n", hipGetErrorName(le));
}
extern "C" void kernel_launch(void* const* d_in, const int* in_sizes, int n_in, void* d_out, int out_size, void* d_ws, size_t ws_size, hipStream_t stream) {
    fast_forward(d_in, (float*)d_out, (unsigned char*)d_ws, stream, 0, N_PHASES, MK_PER_PHASE != 0);
}
```
